# Optimizing an MI355X kernel written in HIP

```python
import math
import jax, jax.numpy as jnp
from jax import lax
import numpy as np

D_MODEL = 4096
BATCH = 2
SEQ = 4096
DEPTH = 1

MEM_LEN = 256
MIX_WIDTH = D_MODEL
MLSTM_HEADS = 4
MLSTM_V = MIX_WIDTH // 2
MLSTM_DV = MLSTM_V // MLSTM_HEADS
MLSTM_DQK = MLSTM_DV // 2
MLSTM_QK = MLSTM_HEADS * MLSTM_DQK
MLSTM_CHUNK = 64
GATE_CAP = 15.0
CONV_WIDTH = MIX_WIDTH // 2
CONV_K = 3
N_BRANCH = 2
XATTN_HEADS = 4
XATTN_DH = D_MODEL // XATTN_HEADS
D_FF = ((8 * D_MODEL // 3 + 255) // 256) * 256
IN_WIDTH = 2 * MLSTM_QK + 2 * MLSTM_V + 2 * MLSTM_HEADS + 3 * CONV_WIDTH + N_BRANCH * D_MODEL
EPS = 1e-6

kernel_name = "hybrid_mlstm_shortconv_gated_block"


def rms_norm(x, w):
    xf = x.astype(jnp.float32)
    y = xf * lax.rsqrt(jnp.mean(xf * xf, axis=-1, keepdims=True) + EPS)
    return (y * w.astype(jnp.float32)).astype(x.dtype)


def mlstm_chunkwise(q, k, v, i_pre, f_pre):
    out_dtype = v.dtype
    B, S, H, dqk = q.shape
    dv = v.shape[-1]
    L = MLSTM_CHUNK
    nc = S // L
    q = q.astype(jnp.float32) * (dqk ** -0.5)
    k = k.astype(jnp.float32)
    v = v.astype(jnp.float32)
    log_i = i_pre.astype(jnp.float32)
    log_f = jax.nn.log_sigmoid(f_pre.astype(jnp.float32))

    def to_chunks(t):
        return t.reshape(B, nc, L, H, t.shape[-1]).transpose(1, 0, 3, 2, 4)

    def gate_chunks(g):
        return g.reshape(B, nc, L, H).transpose(1, 0, 3, 2)

    mask = jnp.tril(jnp.ones((L, L), dtype=bool))

    def step(carry, xs):
        C, n, m = carry
        qc, kc, vc, li, lf = xs
        b = jnp.cumsum(lf, axis=-1)
        Dm = b[..., :, None] - b[..., None, :] + li[..., None, :]
        Dm = jnp.where(mask, Dm, -jnp.inf)
        inter = b + m[..., None]
        m_row = jnp.maximum(inter, jnp.max(Dm, axis=-1))
        w_intra = jnp.exp(Dm - m_row[..., None])
        s_inter = jnp.exp(inter - m_row)
        qk = jnp.einsum('bhld,bhsd->bhls', qc, kc) * w_intra
        num = s_inter[..., None] * jnp.einsum('bhld,bhde->bhle', qc, C) \
            + jnp.einsum('bhls,bhse->bhle', qk, vc)
        den = s_inter * jnp.einsum('bhld,bhd->bhl', qc, n) + jnp.sum(qk, axis=-1)
        h = num / jnp.maximum(jnp.abs(den), jnp.exp(-m_row))[..., None]
        b_last = b[..., -1]
        a = b_last[..., None] - b + li
        m_new = jnp.maximum(b_last + m, jnp.max(a, axis=-1))
        s_state = jnp.exp(b_last + m - m_new)
        kw = kc * jnp.exp(a - m_new[..., None])[..., None]
        C_new = s_state[..., None, None] * C + jnp.einsum('bhsd,bhse->bhde', kw, vc)
        n_new = s_state[..., None] * n + jnp.sum(kw, axis=-2)
        return (C_new, n_new, m_new), h

    init = (jnp.zeros((B, H, dqk, dv), jnp.float32),
            jnp.zeros((B, H, dqk), jnp.float32),
            jnp.zeros((B, H), jnp.float32))
    xs = (to_chunks(q), to_chunks(k), to_chunks(v), gate_chunks(log_i), gate_chunks(log_f))
    _, h = lax.scan(step, init, xs)
    h = h.transpose(1, 0, 3, 2, 4).reshape(B, S, H, dv)
    return h.astype(out_dtype)


def causal_depthwise_conv(u, w):
    S = u.shape[1]
    up = jnp.pad(u, ((0, 0), (CONV_K - 1, 0), (0, 0)))
    y = w[CONV_K - 1] * up[:, CONV_K - 1:CONV_K - 1 + S, :]
    for j in range(CONV_K - 1):
        y = y + w[j] * up[:, j:j + S, :]
    return y


def hybrid_mixer(h, w_in, b_if, mlstm_head_norm, conv_w, w_branch, w_mix_out):
    B, S, _ = h.shape
    proj = h @ w_in
    sizes = [MLSTM_QK, MLSTM_QK, MLSTM_V, MLSTM_V, MLSTM_HEADS, MLSTM_HEADS,
             CONV_WIDTH, CONV_WIDTH, CONV_WIDTH, N_BRANCH * D_MODEL]
    idx = [int(s) for s in np.cumsum(sizes)[:-1]]
    q, k, v, o_pre, i_pre, f_pre, cb, cc, cx, g_pre = jnp.split(proj, idx, axis=-1)

    q = q.reshape(B, S, MLSTM_HEADS, MLSTM_DQK)
    k = k.reshape(B, S, MLSTM_HEADS, MLSTM_DQK)
    v = v.reshape(B, S, MLSTM_HEADS, MLSTM_DV)
    i_pre = GATE_CAP * jnp.tanh((i_pre + b_if[0]) / GATE_CAP)
    f_pre = GATE_CAP * jnp.tanh((f_pre + b_if[1]) / GATE_CAP)
    hA = mlstm_chunkwise(q, k, v, i_pre, f_pre)
    hA = rms_norm(hA, mlstm_head_norm.reshape(MLSTM_HEADS, MLSTM_DV))
    hA = jax.nn.sigmoid(o_pre) * hA.reshape(B, S, MLSTM_V)

    hB = cb * causal_depthwise_conv(cc * cx, conv_w)

    ys = jnp.einsum('bsnc,ncd->bsnd', jnp.stack([hA, hB], axis=2), w_branch)
    gates = jax.nn.sigmoid(g_pre.reshape(B, S, N_BRANCH, D_MODEL))
    merged = jnp.sum(gates * ys, axis=2)
    return merged @ w_mix_out


def memory_cross_attention(h, m, w_xq, w_xk, w_xv, w_xo):
    B, S, _ = h.shape
    M = m.shape[1]
    q = (h @ w_xq).reshape(B, S, XATTN_HEADS, XATTN_DH)
    k = (m @ w_xk).reshape(B, M, XATTN_HEADS, XATTN_DH)
    v = (m @ w_xv).reshape(B, M, XATTN_HEADS, XATTN_DH)
    s = jnp.einsum('bshd,bmhd->bhsm', q.astype(jnp.float32), k.astype(jnp.float32))
    p = jax.nn.softmax(s * (XATTN_DH ** -0.5), axis=-1).astype(v.dtype)
    o = jnp.einsum('bhsm,bmhd->bshd', p, v).reshape(B, S, XATTN_HEADS * XATTN_DH)
    return o @ w_xo


def swiglu_ffn(h, w_gate, w_up, w_down):
    return (jax.nn.silu(h @ w_gate) * (h @ w_up)) @ w_down


def setup_inputs(seed: int = 0) -> dict:
    key = jax.random.key(seed)
    ks = jax.random.split(key, 24)

    def nrm(k, shape, scale):
        return jax.random.normal(k, shape, jnp.float32) * scale

    def gain(k, shape):
        return 1.0 + 0.02 * jax.random.normal(k, shape, jnp.float32)

    b_i = 0.1 * jax.random.normal(ks[4], (DEPTH, MLSTM_HEADS), jnp.float32)
    b_f = jnp.linspace(3.0, 6.0, MLSTM_HEADS, dtype=jnp.float32)[None, :] \
        + 0.1 * jax.random.normal(ks[5], (DEPTH, MLSTM_HEADS), jnp.float32)
    return {
        "x": nrm(ks[0], (BATCH, SEQ, D_MODEL), 1.0),
        "mem": nrm(ks[1], (BATCH, MEM_LEN, D_MODEL), 1.0),
        "norm_pre_mix": gain(ks[2], (DEPTH, D_MODEL)),
        "norm_post_mix": gain(ks[3], (DEPTH, D_MODEL)),
        "w_in": nrm(ks[6], (DEPTH, D_MODEL, IN_WIDTH), D_MODEL ** -0.5),
        "b_if": jnp.stack([b_i, b_f], axis=1),
        "mlstm_head_norm": gain(ks[7], (DEPTH, MLSTM_V)),
        "conv_w": nrm(ks[8], (DEPTH, CONV_K, CONV_WIDTH), CONV_K ** -0.5),
        "w_branch": nrm(ks[9], (DEPTH, N_BRANCH, MLSTM_V, D_MODEL), MLSTM_V ** -0.5),
        "w_mix_out": nrm(ks[10], (DEPTH, D_MODEL, D_MODEL), D_MODEL ** -0.5),
        "norm_pre_xattn": gain(ks[11], (DEPTH, D_MODEL)),
        "norm_post_xattn": gain(ks[12], (DEPTH, D_MODEL)),
        "norm_mem": gain(ks[13], (DEPTH, D_MODEL)),
        "w_xq": nrm(ks[14], (DEPTH, D_MODEL, XATTN_HEADS * XATTN_DH), D_MODEL ** -0.5),
        "w_xk": nrm(ks[15], (DEPTH, D_MODEL, XATTN_HEADS * XATTN_DH), D_MODEL ** -0.5),
        "w_xv": nrm(ks[16], (DEPTH, D_MODEL, XATTN_HEADS * XATTN_DH), D_MODEL ** -0.5),
        "w_xo": nrm(ks[17], (DEPTH, XATTN_HEADS * XATTN_DH, D_MODEL), (XATTN_HEADS * XATTN_DH) ** -0.5),
        "norm_pre_ffn": gain(ks[18], (DEPTH, D_MODEL)),
        "norm_post_ffn": gain(ks[19], (DEPTH, D_MODEL)),
        "w_ffn_gate": nrm(ks[20], (DEPTH, D_MODEL, D_FF), D_MODEL ** -0.5),
        "w_ffn_up": nrm(ks[21], (DEPTH, D_MODEL, D_FF), D_MODEL ** -0.5),
        "w_ffn_down": nrm(ks[22], (DEPTH, D_FF, D_MODEL), D_FF ** -0.5),
    }


def reference(x, mem, norm_pre_mix, norm_post_mix, w_in, b_if, mlstm_head_norm, conv_w,
              w_branch, w_mix_out, norm_pre_xattn, norm_post_xattn, norm_mem,
              w_xq, w_xk, w_xv, w_xo, norm_pre_ffn, norm_post_ffn,
              w_ffn_gate, w_ffn_up, w_ffn_down):
    for l in range(DEPTH):
        h = rms_norm(x, norm_pre_mix[l])
        y = hybrid_mixer(h, w_in[l], b_if[l], mlstm_head_norm[l], conv_w[l],
                         w_branch[l], w_mix_out[l])
        x = x + rms_norm(y, norm_post_mix[l])
        h = rms_norm(x, norm_pre_xattn[l])
        m = rms_norm(mem, norm_mem[l])
        y = memory_cross_attention(h, m, w_xq[l], w_xk[l], w_xv[l], w_xo[l])
        x = x + rms_norm(y, norm_post_xattn[l])
        h = rms_norm(x, norm_pre_ffn[l])
        y = swiglu_ffn(h, w_ffn_gate[l], w_ffn_up[l], w_ffn_down[l])
        x = x + rms_norm(y, norm_post_ffn[l])
    return x
```

```cpp
#include <hip/hip_runtime.h>
#include <cstdio>
#include <cstdint>

#ifndef DBG_STOP
#define DBG_STOP -1
#endif
#ifndef DBG_OFF0
#define DBG_OFF0 WS_Q
#define DBG_OFF1 WS_UT
#define DBG_HB 1
#endif
#ifndef MK_PER_PHASE
#define MK_PER_PHASE 1
#endif

#define LAS __attribute__((address_space(3)))
#define GAS __attribute__((address_space(1)))
typedef unsigned short bf16_t;
typedef short bf16x8 __attribute__((ext_vector_type(8)));
typedef float f32x4 __attribute__((ext_vector_type(4)));
typedef float f32x2 __attribute__((ext_vector_type(2)));
typedef unsigned u32x4 __attribute__((ext_vector_type(4)));
typedef unsigned u32x2 __attribute__((ext_vector_type(2)));

constexpr int NB = 2, SEQ = 4096, DM = 4096, MT = NB * SEQ;
constexpr int NHD = 4, DQK = 256, DV = 512, QKW = 1024, VWD = 2048, CWD = 2048;
constexpr int INW = 20488, NPROJ = 20480;
constexpr int MEML = 256, XH = 4, XDH = 1024, FF = 11008, NGU = 2 * FF;
constexpr int LCH = 64, NCH = SEQ / LCH, NBH = NB * NHD;
constexpr float EPS = 1e-6f, GATE_CAP = 15.0f;
constexpr int NWAVES = 8, NTHR = 512;

constexpr size_t WS_CTL = 0, CTL_BYTES = 1u << 20;
constexpr size_t WS_WIN = WS_CTL + CTL_BYTES;
constexpr size_t WS_WG = WS_WIN + (size_t)NPROJ * DM * 2;
constexpr size_t WS_WBR = WS_WG + (size_t)16 * DM * 2;
constexpr size_t WS_WMIX = WS_WBR + (size_t)2 * DM * VWD * 2;
constexpr size_t WS_WXQ = WS_WMIX + (size_t)DM * DM * 2;
constexpr size_t WS_WXK = WS_WXQ + (size_t)DM * DM * 2;
constexpr size_t WS_WXV = WS_WXK + (size_t)DM * DM * 2;
constexpr size_t WS_WXO = WS_WXV + (size_t)DM * DM * 2;
constexpr size_t WS_WGU = WS_WXO + (size_t)DM * DM * 2;
constexpr size_t WS_WD = WS_WGU + (size_t)NGU * DM * 2;
constexpr size_t WS_H = WS_WD + (size_t)DM * FF * 2;
constexpr size_t WS_MN = WS_H + (size_t)MT * DM * 2;
constexpr size_t WS_KX = WS_MN + (size_t)NB * MEML * DM * 2;
constexpr size_t WS_VX = WS_KX + (size_t)NB * MEML * DM * 2;
constexpr size_t WS_GT = WS_VX + (size_t)NB * MEML * DM * 2;
constexpr size_t WS_VWT = WS_GT + (size_t)NB * XH * MEML * DM * 2;
constexpr size_t WS_G8 = WS_VWT + (size_t)NB * XH * MEML * DM * 2;
constexpr size_t WS_Q = WS_G8 + (size_t)MT * 8 * 4;
constexpr size_t WS_KN = WS_Q + (size_t)MT * QKW * 2;
constexpr size_t WS_KT = WS_KN + (size_t)MT * QKW * 2;
constexpr size_t WS_VT = WS_KT + (size_t)MT * QKW * 2;
constexpr size_t WS_SO = WS_VT + (size_t)MT * VWD * 2;
constexpr size_t WS_CB = WS_SO + (size_t)MT * VWD * 2;
constexpr size_t WS_CC = WS_CB + (size_t)MT * CWD * 2;
constexpr size_t WS_CX = WS_CC + (size_t)MT * CWD * 2;
constexpr size_t WS_SG = WS_CX + (size_t)MT * CWD * 2;
constexpr size_t WS_UT = WS_SG + (size_t)MT * 2 * DM * 2;
constexpr size_t WS_NU = WS_UT + (size_t)NBH * NCH * DV * DQK * 2;
constexpr size_t WS_SUMM = WS_NU + (size_t)NBH * NCH * DQK * 4;
constexpr size_t WS_MPREV = WS_SUMM + 4096;
constexpr size_t WS_NP = WS_MPREV + 4096;
constexpr size_t WS_HA = WS_NP + (size_t)NBH * NCH * DQK * 4;
constexpr size_t WS_HB = WS_HA + (size_t)MT * VWD * 2;
constexpr size_t WS_END = WS_HB + (size_t)MT * CWD * 2;
constexpr size_t WS_CT = WS_WIN;
constexpr size_t WS_TMP = WS_UT;
constexpr size_t WS_Y = WS_UT;
constexpr size_t WS_MRG = WS_CC;
constexpr size_t WS_SC = WS_CB;
constexpr size_t WS_P = WS_Q;
constexpr size_t WS_ACT = WS_Q;
static_assert((size_t)MT * DM * 4 <= (size_t)NBH * NCH * DV * DQK * 2 + 0, "Y/TMP fit the UT region");
static_assert(WS_ACT + (size_t)MT * FF * 2 <= WS_UT, "ACT fits the proj region");
static_assert(WS_END <= 1422147616ull, "workspace");

constexpr int CW_BAR = 4096;

constexpr int RING_BYTES = 131072, LDSCTL_OFF = RING_BYTES, MISC_OFF = LDSCTL_OFF + 320, LDS_BYTES = 147456;

typedef __bf16 bf16x2_t __attribute__((ext_vector_type(2)));
__device__ __forceinline__ unsigned cvt_pk_bf16(float lo, float hi) { const f32x2 v = {lo, hi}; return __builtin_bit_cast(unsigned, __builtin_convertvector(v, bf16x2_t)); }
__device__ __forceinline__ float bf_lo(unsigned w) { return __uint_as_float(w << 16); }
__device__ __forceinline__ float bf_hi(unsigned w) { return __uint_as_float(w & 0xffff0000u); }
__device__ __forceinline__ float sigmoidf_(float x) { return __builtin_amdgcn_rcpf(1.0f + __expf(-x)); }
__device__ __forceinline__ float wave_sum(float v) {
#pragma unroll
    for (int o = 1; o < 64; o <<= 1) v += __shfl_xor(v, o);
    return v;
}
__device__ __forceinline__ float wave_max(float v) {
#pragma unroll
    for (int o = 1; o < 64; o <<= 1) v = fmaxf(v, __shfl_xor(v, o));
    return v;
}
#define LDS_WAIT() asm volatile("s_waitcnt lgkmcnt(0)" ::: "memory")
#define VM_WAIT() asm volatile("s_waitcnt vmcnt(0)" ::: "memory")

namespace pg8 {
constexpr int BM = 256, BK = 64, HALF = 128, HTB = HALF * BK * 2, STAGE_BYTES = 8 * HTB, NXCD = 8, WGM = 8;
__host__ __device__ __forceinline__ int lds_byte(int r, int c) { const int st = (r >> 4) * 2 + (c >> 5), rr = r & 15, cc = c & 31, ob = rr * 64 + cc * 2; return st * 1024 + (ob ^ (((ob >> 9) & 1) << 5)); }
__host__ __device__ __forceinline__ void stage_rc(int b, int& R, int& C) { const int st = b / 1024, sb = b % 1024, swz = sb ^ (((sb >> 9) & 1) << 5); R = (st >> 1) * 16 + swz / 64; C = (st & 1) * 32 + (swz % 64) / 2; }
__host__ __device__ __forceinline__ int perm32(int rho) { const int n = rho >> 4, i = rho & 15; return 8 * (i >> 2) + 4 * n + (i & 3); }

struct Unit { const char* A; const char* B; int pm, pn, kind; };
struct TileOrder {
    int nM, nN, nwg, G, c;
    __device__ void init(int nM_, int nN_, int G_, int c_) { nM = nM_; nN = nN_; nwg = nM * nN; G = G_; c = c_; }
    __device__ bool tile(int i, int& pm, int& pn) const {
        const long L = (long)i * G + c; if (L >= nwg) return false;
        int wgid = (int)L; { const int q = nwg / NXCD, r = nwg % NXCD, xcd = wgid % NXCD, off = wgid / NXCD; wgid = (xcd < r ? xcd * (q + 1) : r * (q + 1) + (xcd - r) * q) + off; }
        const int nig = WGM * nN, gid = wgid / nig, fm = gid * WGM, gsz = (nM - fm) < WGM ? (nM - fm) : WGM;
        pm = fm + ((wgid % nig) % gsz); pn = (wgid % nig) / gsz; return true;
    }
};

template <class Epi, class Sched, bool ALIGN_EPI, bool SP2>
__device__ __forceinline__ void gemm_phase(LAS unsigned char* lds, const int lda, const int ldb, const int K, const Sched& S, const Epi& E) {
    const int tid = threadIdx.x, wid = __builtin_amdgcn_readfirstlane(tid >> 6), lane = tid & 63, wr = wid >> 2, wc = wid & 3, fr = lane & 15, fq = lane >> 4;
    const int nt = K / BK;
    unsigned voffA[2], voffB[2];
#pragma unroll
    for (int i = 0; i < 2; ++i) { int R, C; stage_rc(tid * 16 + i * 8192, R, C); const int Rb = Epi::PERM ? ((R & ~31) + perm32(R & 31)) : R;
        voffA[i] = (unsigned)(R * lda + C) * 2u; voffB[i] = (unsigned)(Rb * ldb + C) * 2u; }
    const size_t kstep = (size_t)(BK * 2);
    const size_t hstepA = (size_t)HALF * lda * 2, hstepB = (size_t)HALF * ldb * 2;
    const unsigned ldsw = (unsigned)wid * 1024u;
    const int aoff = lds_byte(wr * 64 + fr, fq * 8), boff = lds_byte(wc * 32 + fr, fq * 8);
#define PG8_SA(b, h) (((b) * 2 + (h)) * HTB)
#define PG8_SB(b, h) ((4 + (b) * 2 + (h)) * HTB)
#define PG8_STAGE(bufoff, gbase, voff) do { _Pragma("unroll") for (int _i = 0; _i < 2; ++_i) \
        __builtin_amdgcn_global_load_lds((const unsigned*)((const char*)(gbase) + (voff)[_i]), (LAS unsigned*)(lds + (bufoff) + ldsw + _i * 8192), 16, 0, 0); } while (0)
#define PG8_LDA(dst, b, h) do { _Pragma("unroll") for (int m = 0; m < 4; ++m) _Pragma("unroll") for (int k = 0; k < 2; ++k) dst[m][k] = *(const LAS bf16x8*)(lds + PG8_SA(b, h) + aoff + m * 2048 + k * 1024); } while (0)
#define PG8_LDB(dst, b, h) do { _Pragma("unroll") for (int n = 0; n < 2; ++n) _Pragma("unroll") for (int k = 0; k < 2; ++k) dst[n][k] = *(const LAS bf16x8*)(lds + PG8_SB(b, h) + boff + n * 2048 + k * 1024); } while (0)
#define PG8_MMA(ai, bj, At, Bt) do { __builtin_amdgcn_s_setprio(1); _Pragma("unroll") for (int m = 0; m < 4; ++m) _Pragma("unroll") for (int n = 0; n < 2; ++n) _Pragma("unroll") for (int k = 0; k < 2; ++k) \
        acc[ai][bj][m][n] = __builtin_amdgcn_mfma_f32_16x16x32_bf16(Bt[n][k], At[m][k], acc[ai][bj][m][n], 0, 0, 0); __builtin_amdgcn_s_setprio(0); } while (0)
#define PG8_WAIT_V(n) asm volatile("s_waitcnt vmcnt(" #n ")" ::: "memory")
#define PG8_WAIT_L(n) asm volatile("s_waitcnt lgkmcnt(" #n ")" ::: "memory")
#define PG8_BAR __builtin_amdgcn_s_barrier()
#define PG8_SCHED __builtin_amdgcn_sched_barrier(0)
    Unit cur, nxt; int ui = 0;
    if (!S.next(0, cur)) return;
    f32x4 acc[2][2][4][2];
#pragma unroll
    for (int a = 0; a < 2; ++a)
#pragma unroll
        for (int b = 0; b < 2; ++b)
#pragma unroll
            for (int m = 0; m < 4; ++m)
#pragma unroll
                for (int n = 0; n < 2; ++n) acc[a][b][m][n] = (f32x4){0.f, 0.f, 0.f, 0.f};
    bf16x8 At[4][2], B0[2][2], B1[2][2];
    const char* cA = cur.A; const char* cB = cur.B;
    if constexpr (SP2) {
        PG8_STAGE(PG8_SB(0, 0), cB, voffB); PG8_STAGE(PG8_SB(0, 1), cB + hstepB, voffB); PG8_STAGE(PG8_SA(0, 0), cA, voffA); PG8_STAGE(PG8_SA(0, 1), cA + hstepA, voffA);
        if (wr == 1) PG8_BAR;
        PG8_WAIT_V(2); PG8_BAR;
        PG8_STAGE(PG8_SB(1, 0), cB + kstep, voffB); PG8_STAGE(PG8_SA(1, 0), cA + kstep, voffA); PG8_STAGE(PG8_SB(1, 1), cB + hstepB + kstep, voffB);
        PG8_WAIT_V(6); PG8_BAR;
    } else {
        PG8_STAGE(PG8_SB(0, 0), cB, voffB); PG8_STAGE(PG8_SA(0, 0), cA, voffA); PG8_STAGE(PG8_SB(0, 1), cB + hstepB, voffB); PG8_STAGE(PG8_SA(0, 1), cA + hstepA, voffA);
        if (wr == 1) PG8_BAR;
        PG8_WAIT_V(4); PG8_BAR;
        PG8_STAGE(PG8_SB(1, 0), cB + kstep, voffB); PG8_STAGE(PG8_SA(1, 0), cA + kstep, voffA); PG8_STAGE(PG8_SB(1, 1), cB + hstepB + kstep, voffB);
        PG8_WAIT_V(6); PG8_BAR;
    }
    for (;;) {
        const bool has_next = S.next(ui + 1, nxt);
        const char* nA = has_next ? nxt.A : cA; const char* nB = has_next ? nxt.B : cB;
        for (int t = 0; t < nt; t += 2) {
            const bool last = (t == nt - 2);
            const char* a1 = cA + (size_t)(t + 1) * kstep;
            const char* a2 = last ? nA : cA + (size_t)(t + 2) * kstep; const char* b2 = last ? nB : cB + (size_t)(t + 2) * kstep;
            const char* a3 = a2 + kstep; const char* b3 = b2 + kstep;
            if constexpr (SP2) {
            PG8_LDB(B0, 0, 0); PG8_LDB(B1, 0, 1); PG8_SCHED; PG8_LDA(At, 0, 0); PG8_STAGE(PG8_SA(1, 1), a1 + hstepA, voffA);
            PG8_WAIT_V(8); PG8_WAIT_L(0); PG8_BAR; PG8_MMA(0, 0, At, B0); PG8_MMA(0, 1, At, B1); PG8_BAR; PG8_SCHED;
            PG8_LDA(At, 0, 1); PG8_STAGE(PG8_SB(0, 0), b2, voffB); PG8_STAGE(PG8_SB(0, 1), b2 + hstepB, voffB); PG8_STAGE(PG8_SA(0, 0), a2, voffA);
            PG8_WAIT_V(8); PG8_WAIT_L(0); PG8_BAR; PG8_MMA(1, 0, At, B0); PG8_MMA(1, 1, At, B1); PG8_BAR; PG8_SCHED;
            PG8_LDB(B0, 1, 0); PG8_LDB(B1, 1, 1); PG8_SCHED; PG8_LDA(At, 1, 0); PG8_STAGE(PG8_SA(0, 1), a2 + hstepA, voffA);
            PG8_WAIT_V(8); PG8_WAIT_L(0); PG8_BAR; PG8_MMA(0, 0, At, B0); PG8_MMA(0, 1, At, B1); PG8_BAR; PG8_SCHED;
            PG8_LDA(At, 1, 1); PG8_STAGE(PG8_SB(1, 0), b3, voffB); PG8_STAGE(PG8_SB(1, 1), b3 + hstepB, voffB); PG8_STAGE(PG8_SA(1, 0), a3, voffA);
            PG8_WAIT_V(8); PG8_WAIT_L(0); PG8_BAR; PG8_MMA(1, 0, At, B0); PG8_MMA(1, 1, At, B1); PG8_BAR; PG8_SCHED;
            } else {
            PG8_LDB(B0, 0, 0); PG8_SCHED; PG8_LDA(At, 0, 0); PG8_STAGE(PG8_SA(1, 1), a1 + hstepA, voffA);
            PG8_WAIT_L(8); PG8_BAR; PG8_WAIT_L(0); PG8_MMA(0, 0, At, B0); PG8_BAR; PG8_SCHED;
            PG8_LDB(B1, 0, 1); PG8_STAGE(PG8_SB(0, 0), b2, voffB);
            PG8_BAR; PG8_WAIT_L(0); PG8_MMA(0, 1, At, B1); PG8_BAR;
            PG8_LDA(At, 0, 1); PG8_STAGE(PG8_SA(0, 0), a2, voffA);
            PG8_BAR; PG8_WAIT_L(0); PG8_MMA(1, 0, At, B0); PG8_BAR; PG8_SCHED;
            PG8_STAGE(PG8_SB(0, 1), b2 + hstepB, voffB);
            PG8_WAIT_V(6); PG8_BAR; PG8_MMA(1, 1, At, B1); PG8_BAR;
            PG8_LDB(B0, 1, 0); PG8_SCHED; PG8_LDA(At, 1, 0); PG8_STAGE(PG8_SA(0, 1), a2 + hstepA, voffA);
            PG8_WAIT_L(8); PG8_BAR; PG8_WAIT_L(0); PG8_MMA(0, 0, At, B0); PG8_BAR; PG8_SCHED;
            PG8_LDB(B1, 1, 1); PG8_STAGE(PG8_SB(1, 0), b3, voffB);
            PG8_BAR; PG8_WAIT_L(0); PG8_MMA(0, 1, At, B1); PG8_BAR;
            PG8_LDA(At, 1, 1); PG8_STAGE(PG8_SA(1, 0), a3, voffA);
            PG8_BAR; PG8_WAIT_L(0); PG8_MMA(1, 0, At, B0); PG8_BAR; PG8_SCHED;
            PG8_STAGE(PG8_SB(1, 1), b3 + hstepB, voffB);
            PG8_WAIT_V(6); PG8_BAR; PG8_MMA(1, 1, At, B1); PG8_BAR;
            }
        }
        if constexpr (ALIGN_EPI) { if (wr == 0) PG8_BAR; }
        E(acc, cur, wr, wc, fr, fq);
        if (!has_next) break;
#pragma unroll
        for (int a = 0; a < 2; ++a)
#pragma unroll
            for (int b = 0; b < 2; ++b)
#pragma unroll
                for (int m = 0; m < 4; ++m)
#pragma unroll
                    for (int n = 0; n < 2; ++n) acc[a][b][m][n] = (f32x4){0.f, 0.f, 0.f, 0.f};
        cur = nxt; cA = nA; cB = nB; ++ui;
        if constexpr (ALIGN_EPI) { if (wr == 1) PG8_BAR; }
    }
    PG8_WAIT_V(0);
    if constexpr (!ALIGN_EPI) { if (wr == 0) PG8_BAR; }
    PG8_BAR;
#undef PG8_SA
#undef PG8_SB
#undef PG8_STAGE
#undef PG8_LDA
#undef PG8_LDB
#undef PG8_MMA
#undef PG8_WAIT_V
#undef PG8_WAIT_L
#undef PG8_BAR
#undef PG8_SCHED
}
}
using pg8::Unit;
using pg8::HALF;

__device__ __forceinline__ void store_tile_bf16(const f32x4 (&acc)[2][2][4][2], bf16_t* base, size_t ldc, int mode, float scale, int wr, int wc, int fr, int fq) {
    const int row0 = wr * 64 + fr, col0 = wc * 32 + 8 * fq;
#pragma unroll
    for (int ai = 0; ai < 2; ++ai)
#pragma unroll
        for (int m = 0; m < 4; ++m) { bf16_t* rowp = base + (size_t)(row0 + ai * HALF + m * 16) * ldc + col0;
#pragma unroll
            for (int bj = 0; bj < 2; ++bj) { f32x4 v0 = acc[ai][bj][m][0], v1 = acc[ai][bj][m][1];
                if (mode == 1) {
#pragma unroll
                    for (int j = 0; j < 4; ++j) { v0[j] = sigmoidf_(v0[j]); v1[j] = sigmoidf_(v1[j]); }
                } else { v0 = v0 * scale; v1 = v1 * scale; }
                u32x4 w; w.x = cvt_pk_bf16(v0[0], v0[1]); w.y = cvt_pk_bf16(v0[2], v0[3]); w.z = cvt_pk_bf16(v1[0], v1[1]); w.w = cvt_pk_bf16(v1[2], v1[3]);
                *(u32x4*)(rowp + bj * HALF) = w; } }
}
__device__ __forceinline__ void store_tile_f32(const f32x4 (&acc)[2][2][4][2], float* base, size_t ldc, int wr, int wc, int fr, int fq) {
    const int row0 = wr * 64 + fr, col0 = wc * 32 + 4 * fq;
#pragma unroll
    for (int ai = 0; ai < 2; ++ai)
#pragma unroll
        for (int m = 0; m < 4; ++m) { float* rowp = base + (size_t)(row0 + ai * HALF + m * 16) * ldc + col0;
#pragma unroll
            for (int bj = 0; bj < 2; ++bj)
#pragma unroll
                for (int n = 0; n < 2; ++n) *(f32x4*)(rowp + bj * HALF + n * 16) = acc[ai][bj][m][n]; }
}

struct EpiProj {
    static constexpr bool PERM = true;
    bf16_t *Q, *KN, *KT, *VT, *SO, *CB, *CC, *CX, *SG;
    __device__ __forceinline__ void operator()(const f32x4 (&acc)[2][2][4][2], const Unit& u, int wr, int wc, int fr, int fq) const {
        const int pn = u.pn, pm = u.pm; bf16_t* base; size_t ldc; int mode = 0; float scale = 1.0f;
        if (pn < 4) { base = Q + (size_t)pm * 256 * QKW + pn * 256; ldc = QKW; scale = 0.0625f; }
        else if (pn < 8) { base = KN + (size_t)pm * 256 * QKW + (pn - 4) * 256; ldc = QKW; }
        else if (pn < 16) { base = VT + (size_t)(pn - 8) * 256 * MT + pm * 256; ldc = MT; }
        else if (pn < 24) { base = SO + (size_t)pm * 256 * VWD + (pn - 16) * 256; ldc = VWD; mode = 1; }
        else if (pn < 32) { base = CB + (size_t)pm * 256 * CWD + (pn - 24) * 256; ldc = CWD; }
        else if (pn < 40) { base = CC + (size_t)pm * 256 * CWD + (pn - 32) * 256; ldc = CWD; }
        else if (pn < 48) { base = CX + (size_t)pm * 256 * CWD + (pn - 40) * 256; ldc = CWD; }
        else { base = SG + (size_t)pm * 256 * (2 * DM) + (pn - 48) * 256; ldc = 2 * DM; mode = 1; }
        store_tile_bf16(acc, base, ldc, mode, scale, wr, wc, fr, fq);
        if (pn >= 4 && pn < 8) {
            const int row0 = pm * 256 + wr * 64 + fr, col0 = (pn - 4) * 256 + wc * 32 + 8 * fq;
#pragma unroll
            for (int ai = 0; ai < 2; ++ai)
#pragma unroll
                for (int m = 0; m < 4; ++m)
#pragma unroll
                    for (int bj = 0; bj < 2; ++bj)
#pragma unroll
                        for (int n = 0; n < 2; ++n)
#pragma unroll
                            for (int j = 0; j < 4; ++j) {
                                const unsigned w = cvt_pk_bf16(acc[ai][bj][m][n][j], 0.f);
                                KT[(size_t)(col0 + bj * HALF + 4 * n + j) * MT + row0 + ai * HALF + m * 16] = (bf16_t)(w & 0xffffu); }
        }
    }
};
struct EpiBf16To {
    static constexpr bool PERM = true;
    bf16_t* KX; bf16_t* VX; bf16_t* GT; bf16_t* VWT; int which;
    __device__ __forceinline__ void operator()(const f32x4 (&acc)[2][2][4][2], const Unit& u, int wr, int wc, int fr, int fq) const {
        bf16_t* base; size_t ldc;
        if (which == 0) { base = (u.kind == 0 ? KX : VX) + (size_t)u.pm * 256 * DM + u.pn * 256; ldc = DM; }
        else if (u.kind == 0) { base = GT + (size_t)u.pm * 256 * DM + u.pn * 256; ldc = DM; }
        else { base = VWT + (size_t)u.pm * 256 * (XH * MEML) + u.pn * 256; ldc = XH * MEML; }
        store_tile_bf16(acc, base, ldc, 0, 1.0f, wr, wc, fr, fq);
    }
};
struct EpiF32To {
    static constexpr bool PERM = false;
    float* C; int ldc;
    __device__ __forceinline__ void operator()(const f32x4 (&acc)[2][2][4][2], const Unit& u, int wr, int wc, int fr, int fq) const {
        store_tile_f32(acc, C + (size_t)u.pm * 256 * ldc + u.pn * 256, (size_t)ldc, wr, wc, fr, fq);
    }
};
struct EpiMerge {
    static constexpr bool PERM = true;
    const bf16_t* SG; float* TMP; bf16_t* MRG;
    __device__ __forceinline__ void operator()(const f32x4 (&acc)[2][2][4][2], const Unit& u, int wr, int wc, int fr, int fq) const {
        const int row0 = u.pm * 256 + wr * 64 + fr, col0 = u.pn * 256 + wc * 32 + 8 * fq;
#pragma unroll
        for (int ai = 0; ai < 2; ++ai)
#pragma unroll
            for (int m = 0; m < 4; ++m) { const size_t r = (size_t)(row0 + ai * HALF + m * 16);
#pragma unroll
                for (int bj = 0; bj < 2; ++bj) { const int c = col0 + bj * HALF;
                    const u32x4 g = *(const u32x4*)(SG + r * (2 * DM) + (size_t)u.kind * DM + c);
                    f32x4 v0 = acc[ai][bj][m][0], v1 = acc[ai][bj][m][1];
                    v0[0] *= bf_lo(g.x); v0[1] *= bf_hi(g.x); v0[2] *= bf_lo(g.y); v0[3] *= bf_hi(g.y);
                    v1[0] *= bf_lo(g.z); v1[1] *= bf_hi(g.z); v1[2] *= bf_lo(g.w); v1[3] *= bf_hi(g.w);
                    float* tp = TMP + r * DM + c;
                    if (u.kind == 0) { *(f32x4*)tp = v0; *(f32x4*)(tp + 4) = v1; }
                    else { v0 = v0 + *(const f32x4*)tp; v1 = v1 + *(const f32x4*)(tp + 4);
                        u32x4 w; w.x = cvt_pk_bf16(v0[0], v0[1]); w.y = cvt_pk_bf16(v0[2], v0[3]); w.z = cvt_pk_bf16(v1[0], v1[1]); w.w = cvt_pk_bf16(v1[2], v1[3]);
                        *(u32x4*)(MRG + r * DM + c) = w; } } }
    }
};
struct EpiSwiGLU {
    static constexpr bool PERM = true;
    bf16_t* ACT;
    __device__ __forceinline__ void operator()(const f32x4 (&acc)[2][2][4][2], const Unit& u, int wr, int wc, int fr, int fq) const {
        const int row0 = u.pm * 256 + wr * 64 + fr, col0 = u.pn * 128 + wc * 32 + 8 * fq;
#pragma unroll
        for (int ai = 0; ai < 2; ++ai)
#pragma unroll
            for (int m = 0; m < 4; ++m) { bf16_t* rowp = ACT + (size_t)(row0 + ai * HALF + m * 16) * FF + col0;
                f32x4 o0, o1;
#pragma unroll
                for (int j = 0; j < 4; ++j) { const float g0 = acc[ai][0][m][0][j], g1 = acc[ai][0][m][1][j];
                    o0[j] = g0 * sigmoidf_(g0) * acc[ai][1][m][0][j]; o1[j] = g1 * sigmoidf_(g1) * acc[ai][1][m][1][j]; }
                u32x4 w; w.x = cvt_pk_bf16(o0[0], o0[1]); w.y = cvt_pk_bf16(o0[2], o0[3]); w.z = cvt_pk_bf16(o1[0], o1[1]); w.w = cvt_pk_bf16(o1[2], o1[3]);
                *(u32x4*)rowp = w; }
    }
};

struct SchedProj {
    pg8::TileOrder T; const char* Hb; const char* Wb;
    __device__ bool next(int i, Unit& u) const { int pm, pn; if (!T.tile(i, pm, pn)) return false; u.pm = pm; u.pn = pn;
        const char* a = Hb + (size_t)pm * 256 * DM * 2; const char* w = Wb + (size_t)pn * 256 * DM * 2;
        if (pn >= 8 && pn < 16) { u.kind = 1; u.A = w; u.B = a; } else { u.kind = 0; u.A = a; u.B = w; } return true; }
};
struct SchedKV {
    int G, c; const char* MNb; const char* WKb; const char* WVb;
    __device__ bool next(int i, Unit& u) const { const int L = i * G + c; if (L >= 64) return false; u.kind = L >> 5; u.pm = (L >> 4) & 1; u.pn = L & 15;
        u.A = MNb + (size_t)u.pm * 256 * DM * 2; u.B = (u.kind ? WVb : WKb) + (size_t)u.pn * 256 * DM * 2; return true; }
};
struct SchedGVW {
    int G, c; const char* KXb; const char* VXb; const char* WQb; const char* WOb;
    __device__ bool next(int i, Unit& u) const { const int L = i * G + c; if (L >= 256) return false; const int kind = L >> 7, bh = (L >> 4) & 7, t = L & 15, b = bh >> 2, h = bh & 3; u.kind = kind;
        if (kind == 0) { u.pm = bh; u.pn = t; u.A = KXb + ((size_t)b * 256 * DM + h * XDH) * 2; u.B = WQb + ((size_t)t * 256 * DM + h * XDH) * 2; }
        else { u.pm = b * 16 + t; u.pn = h; u.A = WOb + ((size_t)t * 256 * DM + h * XDH) * 2; u.B = VXb + ((size_t)b * 256 * DM + h * XDH) * 2; }
        return true; }
};
struct SchedPair {
    pg8::TileOrder T; const char* HAb; const char* HBb; const char* Wb;
    __device__ bool next(int i, Unit& u) const { int pm, pn; if (!T.tile(i >> 1, pm, pn)) return false; u.pm = pm; u.pn = pn; u.kind = i & 1;
        u.A = (u.kind ? HBb : HAb) + (size_t)pm * 256 * VWD * 2; u.B = Wb + ((size_t)u.kind * DM + (size_t)pn * 256) * VWD * 2; return true; }
};
struct SchedPlain {
    pg8::TileOrder T; const char* Ab; const char* Bb; size_t lda2, ldb2, bstride;
    __device__ bool next(int i, Unit& u) const { int pm, pn; if (!T.tile(i, pm, pn)) return false; u.pm = pm; u.pn = pn; u.kind = 0;
        u.A = Ab + (size_t)pm * 256 * lda2; u.B = Bb + (size_t)(pm >> 4) * bstride + (size_t)pn * 256 * ldb2; return true; }
};

#define XB_TMO      128
#define XB_XCNT(j)  (256  + 64 * (j))
#define XB_XSUB(j)  (1280 + 64 * (j))
#define XB_XGEN(j)  (2304 + 64 * (j))
#define XB_TOP      3328
#define XB_TOPGEN   3392
#define XCD_BAR_WORDS 3456
#define XB_SPIN_CAP (1u << 18)
__device__ __forceinline__ unsigned xb_ld(unsigned* p)              { return __hip_atomic_load(p, __ATOMIC_RELAXED, __HIP_MEMORY_SCOPE_AGENT); }
__device__ __forceinline__ unsigned xb_add(unsigned* p, unsigned v) { return __hip_atomic_fetch_add(p, v, __ATOMIC_RELAXED, __HIP_MEMORY_SCOPE_AGENT); }
__device__ __forceinline__ unsigned xb_xcc_id() { return (unsigned)__builtin_amdgcn_s_getreg((3 << 11) | 20) & 0xFu; }
#define XB_SPIN(cond, bar) do { unsigned _sp = 0; while (cond) { __builtin_amdgcn_s_sleep(1); \
    if ((++_sp & 255u) == 0u) { if (xb_ld(&(bar)[XB_TMO])) break; if (_sp > XB_SPIN_CAP) { atomicAdd(&(bar)[XB_TMO], 1u); break; } } } } while (0)
struct XcdBarrier { unsigned* bar; unsigned x; volatile LAS unsigned* st; };
__device__ __forceinline__ XcdBarrier xcd_barrier_post(unsigned* bar, volatile LAS unsigned* st) {
    XcdBarrier b; b.bar = bar; b.x = xb_xcc_id(); b.st = st;
    if (threadIdx.x == 0) (void)xb_add(&bar[XB_XCNT(b.x)], 1u);
    return b;
}
__device__ __forceinline__ void xcd_barrier_complete(unsigned* bar, unsigned x, unsigned& nloc, unsigned& nx) {
    const unsigned G = gridDim.x * gridDim.y * gridDim.z;
    unsigned sum, cnt, mine, sp = 0u;
    for (;;) {
        sum = 0u; cnt = 0u; mine = 0u;
#pragma unroll
        for (unsigned j = 0; j < 16; ++j) { const unsigned c = xb_ld(&bar[XB_XCNT(j)]); sum += c; cnt += (c > 0u) ? 1u : 0u; mine = (j == x) ? c : mine; }
        if (sum == G) break;
        __builtin_amdgcn_s_sleep(1);
        if ((++sp & 255u) == 0u) { if (xb_ld(&bar[XB_TMO])) break; if (sp > XB_SPIN_CAP) { atomicAdd(&bar[XB_TMO], 1u); break; } }
    }
    nloc = mine > 0u ? mine : 1u; nx = cnt > 0u ? cnt : 1u;
}
__device__ __forceinline__ void xcd_barrier(const XcdBarrier& b) {
    asm volatile("s_waitcnt vmcnt(0)" ::: "memory");
    __syncthreads();
    if (threadIdx.x == 0) {
        unsigned* bar = b.bar;
        __builtin_amdgcn_s_waitcnt(0);
        unsigned nloc = b.st[0], nx = b.st[1];
        if (nloc == 0u) { xcd_barrier_complete(bar, b.x, nloc, nx); b.st[0] = nloc; b.st[1] = nx; }
        const unsigned old = xb_add(&bar[XB_XSUB(b.x)], 1u);
        const unsigned gen = old / nloc;
        if (old + 1u == (gen + 1u) * nloc) {
            __builtin_amdgcn_fence(__ATOMIC_RELEASE, "agent");
            asm volatile("s_waitcnt vmcnt(0)" ::: "memory");
            const unsigned og = xb_add(&bar[XB_TOP], 1u);
            const unsigned tg = og / nx;
            if (og + 1u == (tg + 1u) * nx) xb_add(&bar[XB_TOPGEN], 1u);
            else XB_SPIN(xb_ld(&bar[XB_TOPGEN]) == tg, bar);
            __builtin_amdgcn_fence(__ATOMIC_ACQUIRE, "agent");
            xb_add(&bar[XB_XGEN(b.x)], 1u);
            asm volatile("s_waitcnt vmcnt(0)" ::: "memory");
        } else {
            XB_SPIN(xb_ld(&bar[XB_XGEN(b.x)]) == gen, bar);
            __builtin_amdgcn_fence(__ATOMIC_ACQUIRE, "agent");
            asm volatile("s_waitcnt vmcnt(0)" ::: "memory");
        }
    }
    __syncthreads();
}

struct Args {
    const float *x, *mem, *n_pre_mix, *n_post_mix, *w_in, *b_if, *hnorm, *conv_w, *w_branch, *w_mix, *n_pre_x, *n_post_x, *n_mem, *w_xq, *w_xk, *w_xv, *w_xo, *n_pre_f, *n_post_f, *w_fg, *w_fu, *w_fd;
    float* out; unsigned char* ws; int ph_lo, ph_hi;
};
struct Frame { LAS unsigned char* lds; int tid, lane, wave, gw, NGW, G; };

__device__ __forceinline__ void tr_item(const float* Wsrc, size_t Nsrc, bf16_t* WTdst, size_t Kp, LAS float* scr, int lane) {
#pragma unroll 8
    for (int i = 0; i < 32; ++i) { const int kk = 2 * i + (lane >> 5); scr[kk * 33 + (lane & 31)] = Wsrc[(size_t)kk * Nsrc + (lane & 31)]; }
    LDS_WAIT(); asm volatile("" ::: "memory");
    const int c = lane & 7;
#pragma unroll
    for (int j = 0; j < 4; ++j) { const int n = (lane >> 3) + 8 * j; const LAS float* s = scr + (8 * c) * 33 + n;
        u32x4 o; o.x = cvt_pk_bf16(s[0 * 33], s[1 * 33]); o.y = cvt_pk_bf16(s[2 * 33], s[3 * 33]); o.z = cvt_pk_bf16(s[4 * 33], s[5 * 33]); o.w = cvt_pk_bf16(s[6 * 33], s[7 * 33]);
        *(u32x4*)(WTdst + (size_t)n * Kp + 8 * c) = o; }
    LDS_WAIT(); asm volatile("" ::: "memory");
}
__device__ __forceinline__ void rms_row_bf16(const float* xrow, const float* w, bf16_t* orow, int lane) {
    const f32x4* xr = (const f32x4*)xrow + lane; f32x4 v[16]; float s = 0.f;
#pragma unroll
    for (int j = 0; j < 16; ++j) { v[j] = xr[64 * j]; s += (v[j].x * v[j].x + v[j].y * v[j].y) + (v[j].z * v[j].z + v[j].w * v[j].w); }
    const float rstd = rsqrtf(wave_sum(s) * (1.0f / DM) + EPS);
    const f32x4* wr_ = (const f32x4*)w + lane; u32x2* o8 = (u32x2*)orow + lane;
#pragma unroll
    for (int j = 0; j < 16; ++j) { const f32x4 g = wr_[64 * j]; u32x2 o; o.x = cvt_pk_bf16(v[j].x * rstd * g.x, v[j].y * rstd * g.y); o.y = cvt_pk_bf16(v[j].z * rstd * g.z, v[j].w * rstd * g.w); o8[64 * j] = o; }
}
__device__ __forceinline__ void glue_row(const float* yrow, const float* xold, const float* w_post, float* xout, const float* w_pre, bf16_t* hrow, int lane) {
    const f32x4* yr = (const f32x4*)yrow + lane; const f32x4* xr = (const f32x4*)xold + lane; f32x4 v[16]; float s = 0.f;
#pragma unroll
    for (int j = 0; j < 16; ++j) { v[j] = yr[64 * j]; s += (v[j].x * v[j].x + v[j].y * v[j].y) + (v[j].z * v[j].z + v[j].w * v[j].w); }
    const float rstd = rsqrtf(wave_sum(s) * (1.0f / DM) + EPS);
    const f32x4* wp = (const f32x4*)w_post + lane; f32x4* xo = (f32x4*)xout + lane; float s2 = 0.f;
#pragma unroll
    for (int j = 0; j < 16; ++j) { const f32x4 g = wp[64 * j]; const f32x4 xv = xr[64 * j]; v[j] = xv + v[j] * rstd * g; xo[64 * j] = v[j];
        s2 += (v[j].x * v[j].x + v[j].y * v[j].y) + (v[j].z * v[j].z + v[j].w * v[j].w); }
    if (hrow) {
        const float r2 = rsqrtf(wave_sum(s2) * (1.0f / DM) + EPS);
        const f32x4* wq = (const f32x4*)w_pre + lane; u32x2* o8 = (u32x2*)hrow + lane;
#pragma unroll
        for (int j = 0; j < 16; ++j) { const f32x4 g = wq[64 * j]; u32x2 o; o.x = cvt_pk_bf16(v[j].x * r2 * g.x, v[j].y * r2 * g.y); o.y = cvt_pk_bf16(v[j].z * r2 * g.z, v[j].w * r2 * g.w); o8[64 * j] = o; }
    }
}

__device__ __forceinline__ void chunk_gates(const float* G8, const float* b_if, int tok0, int h, int lane, float& li, float& lf) {
    const float ir = G8[(size_t)(tok0 + lane) * 8 + h] + b_if[h], fr = G8[(size_t)(tok0 + lane) * 8 + 4 + h] + b_if[4 + h];
    li = GATE_CAP * tanhf(ir * (1.0f / GATE_CAP));
    const float fp = GATE_CAP * tanhf(fr * (1.0f / GATE_CAP));
    lf = fp < 0.f ? fp - log1pf(expf(fp)) : -log1pf(expf(-fp));
}
__device__ __forceinline__ float wave_incl_sum(float v, int lane) {
#pragma unroll
    for (int o = 1; o < 64; o <<= 1) { const float t = __shfl_up(v, o); if (lane >= o) v += t; }
    return v;
}
__device__ __forceinline__ float wave_incl_max(float v, int lane) {
#pragma unroll
    for (int o = 1; o < 64; o <<= 1) { const float t = __shfl_up(v, o); if (lane >= o) v = fmaxf(v, t); }
    return v;
}
__device__ __forceinline__ bf16x8 scale_frag(bf16x8 f, const LAS float* w8) {
    const f32x4 w0 = *(const LAS f32x4*)w8, w1 = *(const LAS f32x4*)(w8 + 4);
    u32x4 u = __builtin_bit_cast(u32x4, f);
    u.x = cvt_pk_bf16(bf_lo(u.x) * w0[0], bf_hi(u.x) * w0[1]); u.y = cvt_pk_bf16(bf_lo(u.y) * w0[2], bf_hi(u.y) * w0[3]);
    u.z = cvt_pk_bf16(bf_lo(u.z) * w1[0], bf_hi(u.z) * w1[1]); u.w = cvt_pk_bf16(bf_lo(u.w) * w1[2], bf_hi(u.w) * w1[3]);
    return __builtin_bit_cast(bf16x8, u);
}

constexpr int NPH = 15;
__global__ void __launch_bounds__(NTHR, 2) fwd_kernel(Args args) {
    extern __shared__ __attribute__((aligned(16))) unsigned char lds_raw[];
    Frame F; F.lds = (LAS unsigned char*)lds_raw; F.tid = threadIdx.x; F.lane = F.tid & 63; F.wave = __builtin_amdgcn_readfirstlane(F.tid >> 6);
    F.G = gridDim.x; F.gw = blockIdx.x * NWAVES + F.wave; F.NGW = F.G * NWAVES;
    unsigned char* ws = args.ws;
    const int lo = args.ph_lo, hi = args.ph_hi;
    for (int u = F.tid; u < (LDS_BYTES - LDSCTL_OFF) / 4; u += NTHR) ((LAS unsigned*)(F.lds + LDSCTL_OFF))[u] = 0u;
    __syncthreads();
    XcdBarrier bar; bar.bar = (unsigned*)(ws + WS_CTL) + CW_BAR; bar.x = 0; bar.st = (volatile LAS unsigned*)(F.lds + MISC_OFF + 32);
    if (hi - lo > 1) bar = xcd_barrier_post((unsigned*)(ws + WS_CTL) + CW_BAR, (volatile LAS unsigned*)(F.lds + MISC_OFF + 32));
#define IN(k) (lo <= (k) && (k) < hi)
#define DIGEST(k) do { if (DBG_STOP == (k) && lo == (k) + 1) { const size_t n16 = ((size_t)(DBG_OFF1) - (size_t)(DBG_OFF0)) / 2; const bf16_t* src = (const bf16_t*)(ws + (DBG_OFF0)); \
        for (size_t i = gtid; i < (size_t)MT * DM; i += GT_) { float acc_ = 0.f; for (size_t j = i; j < n16; j += (size_t)MT * DM) acc_ += __uint_as_float((unsigned)src[j] << 16); args.out[i] = acc_; } return; } } while (0)
#define SEAM(k) do { if (IN(k) && IN((k) + 1)) xcd_barrier(bar); } while (0)
    const int gtid = blockIdx.x * NTHR + F.tid, GT_ = F.G * NTHR;

    bf16_t* WIN = (bf16_t*)(ws + WS_WIN); bf16_t* WG = (bf16_t*)(ws + WS_WG); bf16_t* WBR = (bf16_t*)(ws + WS_WBR); bf16_t* WMIX = (bf16_t*)(ws + WS_WMIX);
    bf16_t* WXQ = (bf16_t*)(ws + WS_WXQ); bf16_t* WXK = (bf16_t*)(ws + WS_WXK); bf16_t* WXV = (bf16_t*)(ws + WS_WXV); bf16_t* WXO = (bf16_t*)(ws + WS_WXO);
    bf16_t* WGU = (bf16_t*)(ws + WS_WGU); bf16_t* WD = (bf16_t*)(ws + WS_WD);
    bf16_t* Hb = (bf16_t*)(ws + WS_H); bf16_t* MN = (bf16_t*)(ws + WS_MN); bf16_t* KX = (bf16_t*)(ws + WS_KX); bf16_t* VX = (bf16_t*)(ws + WS_VX);
    bf16_t* GTb = (bf16_t*)(ws + WS_GT); bf16_t* VWT = (bf16_t*)(ws + WS_VWT); float* G8 = (float*)(ws + WS_G8);
    bf16_t* Qb = (bf16_t*)(ws + WS_Q); bf16_t* KN = (bf16_t*)(ws + WS_KN); bf16_t* KT = (bf16_t*)(ws + WS_KT); bf16_t* VT = (bf16_t*)(ws + WS_VT);
    bf16_t* SO = (bf16_t*)(ws + WS_SO); bf16_t* CB = (bf16_t*)(ws + WS_CB); bf16_t* CC = (bf16_t*)(ws + WS_CC); bf16_t* CX = (bf16_t*)(ws + WS_CX); bf16_t* SG = (bf16_t*)(ws + WS_SG);
    bf16_t* UT = (bf16_t*)(ws + WS_UT); float* NU = (float*)(ws + WS_NU); float* SUMM = (float*)(ws + WS_SUMM); float* MPREV = (float*)(ws + WS_MPREV);
    bf16_t* CT = (bf16_t*)(ws + WS_CT); float* NPV = (float*)(ws + WS_NP);
    bf16_t* HA = (bf16_t*)(ws + WS_HA); bf16_t* HBb = (bf16_t*)(ws + WS_HB);
    float* TMP = (float*)(ws + WS_TMP); float* Y = (float*)(ws + WS_Y); bf16_t* MRG = (bf16_t*)(ws + WS_MRG); float* SC = (float*)(ws + WS_SC); bf16_t* Pb = (bf16_t*)(ws + WS_P); bf16_t* ACT = (bf16_t*)(ws + WS_ACT);

    if (IN(0)) {
        LAS float* scr = (LAS float*)(F.lds + F.wave * 16384);
        constexpr int I1 = 64 * 192, I2 = 64 * 448, I3 = 32 * 128, I5 = 64 * 128, I9 = 64 * 344, I11 = 172 * 128;
        constexpr int NIT = I1 + I2 + 2 * I3 + 4 * I5 + 2 * I9 + I11;
        for (int it = F.gw; it < NIT; it += F.NGW) {
            int r = it;
            if (r < I1) { const int kb = r / 192, nb = r % 192; tr_item(args.w_in + (size_t)kb * 64 * INW + nb * 32, INW, WIN + (size_t)nb * 32 * DM + kb * 64, DM, scr, F.lane); continue; } r -= I1;
            if (r < I2) { const int kb = r / 448, nb = r % 448; tr_item(args.w_in + (size_t)kb * 64 * INW + 6152 + nb * 32, INW, WIN + (size_t)(6144 + nb * 32) * DM + kb * 64, DM, scr, F.lane); continue; } r -= I2;
            if (r < 2 * I3) { const int br = r / I3, q = r % I3, kb = q / 128, nb = q % 128; tr_item(args.w_branch + (size_t)br * VWD * DM + (size_t)kb * 64 * DM + nb * 32, DM, WBR + (size_t)br * DM * VWD + (size_t)nb * 32 * VWD + kb * 64, VWD, scr, F.lane); continue; } r -= 2 * I3;
            if (r < 4 * I5) { const int w = r / I5, q = r % I5, kb = q / 128, nb = q % 128;
                const float* src = w == 0 ? args.w_mix : w == 1 ? args.w_xk : w == 2 ? args.w_xv : args.w_xo; bf16_t* dst = w == 0 ? WMIX : w == 1 ? WXK : w == 2 ? WXV : WXO;
                tr_item(src + (size_t)kb * 64 * DM + nb * 32, DM, dst + (size_t)nb * 32 * DM + kb * 64, DM, scr, F.lane); continue; } r -= 4 * I5;
            if (r < 2 * I9) { const int w = r / I9, q = r % I9, kb = q / 344, nb = q % 344, ch0 = nb * 32, row = 256 * (ch0 >> 7) + (ch0 & 127) + 128 * w;
                tr_item((w ? args.w_fu : args.w_fg) + (size_t)kb * 64 * FF + ch0, FF, WGU + (size_t)row * DM + kb * 64, DM, scr, F.lane); continue; } r -= 2 * I9;
            { const int kb = r / 128, nb = r % 128; tr_item(args.w_fd + (size_t)kb * 64 * DM + nb * 32, DM, WD + (size_t)nb * 32 * FF + kb * 64, FF, scr, F.lane); }
        }
        for (size_t i = gtid; i < (size_t)DM * DM / 8; i += GT_) { const f32x4 a = ((const f32x4*)args.w_xq)[2 * i], b = ((const f32x4*)args.w_xq)[2 * i + 1];
            u32x4 o; o.x = cvt_pk_bf16(a.x, a.y); o.y = cvt_pk_bf16(a.z, a.w); o.z = cvt_pk_bf16(b.x, b.y); o.w = cvt_pk_bf16(b.z, b.w); ((u32x4*)WXQ)[i] = o; }
        for (int i = gtid; i < 16 * DM; i += GT_) { const int j = i / DM, k = i % DM; const float v = j < 8 ? args.w_in[(size_t)k * INW + 6144 + j] : 0.f; WG[i] = (bf16_t)(cvt_pk_bf16(v, 0.f) & 0xffffu); }
        for (int m = F.gw; m < MT; m += F.NGW) rms_row_bf16(args.x + (size_t)m * DM, args.n_pre_mix, Hb + (size_t)m * DM, F.lane);
        for (int m = F.gw; m < NB * MEML; m += F.NGW) rms_row_bf16(args.mem + (size_t)m * DM, args.n_mem, MN + (size_t)m * DM, F.lane);
    }
    SEAM(0); DIGEST(0);

    if (IN(1)) {
        {
            LAS float* part = (LAS float*)F.lds;
            for (int rb = blockIdx.x; rb < MT / 32; rb += F.G) {
                const int mt = F.wave >> 2, kq = F.wave & 3, row0 = rb * 32 + mt * 16;
                f32x4 acc = (f32x4){0.f, 0.f, 0.f, 0.f};
                const bf16_t* ap = Hb + (size_t)(row0 + (F.lane & 15)) * DM + kq * 1024 + 8 * (F.lane >> 4);
                const bf16_t* bp = WG + (size_t)(F.lane & 15) * DM + kq * 1024 + 8 * (F.lane >> 4);
#pragma unroll 8
                for (int s = 0; s < 32; ++s) { const bf16x8 a = *(const bf16x8*)(ap + 32 * s), b = *(const bf16x8*)(bp + 32 * s); acc = __builtin_amdgcn_mfma_f32_16x16x32_bf16(a, b, acc, 0, 0, 0); }
#pragma unroll
                for (int r = 0; r < 4; ++r) part[F.wave * 256 + ((F.lane >> 4) * 4 + r) * 16 + (F.lane & 15)] = acc[r];
                __syncthreads();
                { const int t = F.tid, m2 = t >> 8, rr = (t >> 4) & 15, j = t & 15;
                  if (j < 8) { const float v = part[(m2 * 4 + 0) * 256 + rr * 16 + j] + part[(m2 * 4 + 1) * 256 + rr * 16 + j] + part[(m2 * 4 + 2) * 256 + rr * 16 + j] + part[(m2 * 4 + 3) * 256 + rr * 16 + j];
                      G8[(size_t)(rb * 32 + m2 * 16 + rr) * 8 + j] = v; } }
                __syncthreads();
            }
        }
        SchedProj S; S.T.init(MT / 256, NPROJ / 256, F.G, blockIdx.x); S.Hb = (const char*)Hb; S.Wb = (const char*)WIN;
        EpiProj E{Qb, KN, KT, VT, SO, CB, CC, CX, SG};
        pg8::gemm_phase<EpiProj, SchedProj, true, true>(F.lds, DM, DM, DM, S, E);
    }
    SEAM(1); DIGEST(1);

    if (IN(2)) {
        { SchedKV S{F.G, (int)blockIdx.x, (const char*)MN, (const char*)WXK, (const char*)WXV}; EpiBf16To E{KX, VX, GTb, VWT, 0};
          pg8::gemm_phase<EpiBf16To, SchedKV, true, true>(F.lds, DM, DM, DM, S, E); }
        __syncthreads();
        {
            LAS float* wl = (LAS float*)F.lds;
            for (int un = (int)gridDim.x - 1 - (int)blockIdx.x; un < NBH * NCH; un += F.G) {
                const int bh = un / NCH, c = un % NCH, b = bh >> 2, h = bh & 3, tok0 = b * SEQ + c * LCH;
                if (F.wave == 0) {
                    float li, lf; chunk_gates(G8, args.b_if, tok0, h, F.lane, li, lf);
                    const float bc = wave_incl_sum(lf, F.lane); const float g = li - bc; const float gmax = wave_max(g);
                    wl[F.lane] = __expf(g - gmax);
                    if (F.lane == 63) { SUMM[(size_t)un * 2] = bc; SUMM[(size_t)un * 2 + 1] = gmax; }
                }
                __syncthreads();
                const int fr = F.lane & 15, fq = F.lane >> 4;
                bf16x8 vf[4][2];
#pragma unroll
                for (int mt = 0; mt < 4; ++mt)
#pragma unroll
                    for (int ks = 0; ks < 2; ++ks) { const bf16x8 raw = *(const bf16x8*)(VT + (size_t)(h * DV + F.wave * 64 + mt * 16 + fr) * MT + tok0 + 32 * ks + 8 * fq);
                        vf[mt][ks] = scale_frag(raw, wl + 32 * ks + 8 * fq); }
                bf16x8 nf[2];
#pragma unroll
                for (int ks = 0; ks < 2; ++ks) { const f32x4 w0 = *(const LAS f32x4*)(wl + 32 * ks + 8 * fq), w1 = *(const LAS f32x4*)(wl + 32 * ks + 8 * fq + 4);
                    u32x4 u; u.x = cvt_pk_bf16(w0[0], w0[1]); u.y = cvt_pk_bf16(w0[2], w0[3]); u.z = cvt_pk_bf16(w1[0], w1[1]); u.w = cvt_pk_bf16(w1[2], w1[3]);
                    if (fr != 0) u = (u32x4){0u, 0u, 0u, 0u}; nf[ks] = __builtin_bit_cast(bf16x8, u); }
                bf16_t* ut = UT + (size_t)un * DV * DQK; float* nu = NU + (size_t)un * DQK;
                for (int nt = 0; nt < 16; ++nt) {
                    bf16x8 kf[2];
#pragma unroll
                    for (int ks = 0; ks < 2; ++ks) kf[ks] = *(const bf16x8*)(KT + (size_t)(h * DQK + nt * 16 + fr) * MT + tok0 + 32 * ks + 8 * fq);
#pragma unroll
                    for (int mt = 0; mt < 4; ++mt) { f32x4 a = (f32x4){0.f, 0.f, 0.f, 0.f};
                        a = __builtin_amdgcn_mfma_f32_16x16x32_bf16(kf[0], vf[mt][0], a, 0, 0, 0); a = __builtin_amdgcn_mfma_f32_16x16x32_bf16(kf[1], vf[mt][1], a, 0, 0, 0);
                        u32x2 o; o.x = cvt_pk_bf16(a[0], a[1]); o.y = cvt_pk_bf16(a[2], a[3]);
                        *(u32x2*)(ut + (size_t)(F.wave * 64 + mt * 16 + fr) * DQK + nt * 16 + 4 * fq) = o; }
                    if (F.wave == 0) { f32x4 a = (f32x4){0.f, 0.f, 0.f, 0.f};
                        a = __builtin_amdgcn_mfma_f32_16x16x32_bf16(kf[0], nf[0], a, 0, 0, 0); a = __builtin_amdgcn_mfma_f32_16x16x32_bf16(kf[1], nf[1], a, 0, 0, 0);
                        if (fr == 0) *(f32x4*)(nu + nt * 16 + 4 * fq) = a; }
                }
                __syncthreads();
            }
        }
        for (int i = gtid; i < MT * (CWD / 8); i += GT_) {
            const int row = i / (CWD / 8), c8 = (i % (CWD / 8)) * 8, t = row & (SEQ - 1);
            const size_t o = (size_t)row * CWD + c8;
            const u32x4 b4 = *(const u32x4*)(CB + o), c0 = *(const u32x4*)(CC + o), x0 = *(const u32x4*)(CX + o);
            u32x4 c1 = (u32x4){0u, 0u, 0u, 0u}, x1 = c1, c2 = c1, x2 = c1;
            if (t >= 1) { c1 = *(const u32x4*)(CC + o - CWD); x1 = *(const u32x4*)(CX + o - CWD); }
            if (t >= 2) { c2 = *(const u32x4*)(CC + o - 2 * CWD); x2 = *(const u32x4*)(CX + o - 2 * CWD); }
            const float* cw = args.conv_w + c8; float r[8];
#pragma unroll
            for (int q = 0; q < 4; ++q) {
                const unsigned bb = b4[q], a0 = c0[q], y0 = x0[q], a1 = c1[q], y1 = x1[q], a2 = c2[q], y2 = x2[q];
                r[2 * q] = bf_lo(bb) * (cw[2 * CWD + 2 * q] * (bf_lo(a0) * bf_lo(y0)) + cw[CWD + 2 * q] * (bf_lo(a1) * bf_lo(y1)) + cw[2 * q] * (bf_lo(a2) * bf_lo(y2)));
                r[2 * q + 1] = bf_hi(bb) * (cw[2 * CWD + 2 * q + 1] * (bf_hi(a0) * bf_hi(y0)) + cw[CWD + 2 * q + 1] * (bf_hi(a1) * bf_hi(y1)) + cw[2 * q + 1] * (bf_hi(a2) * bf_hi(y2)));
            }
            u32x4 ov; ov.x = cvt_pk_bf16(r[0], r[1]); ov.y = cvt_pk_bf16(r[2], r[3]); ov.z = cvt_pk_bf16(r[4], r[5]); ov.w = cvt_pk_bf16(r[6], r[7]);
            *(u32x4*)(HBb + o) = ov;
        }
    }
    SEAM(2); DIGEST(2);

    if (IN(3)) {
        LAS float* sc = (LAS float*)F.lds;
        if (F.tid < NBH) { float mprev = 0.f;
            for (int c = 0; c < NCH; ++c) { const float bl = SUMM[(size_t)(F.tid * NCH + c) * 2], gm = SUMM[(size_t)(F.tid * NCH + c) * 2 + 1];
                const float Mx = fmaxf(mprev, gm);
                sc[F.tid * NCH + c] = __expf(mprev - Mx); sc[512 + F.tid * NCH + c] = __expf(gm - Mx);
                if (blockIdx.x == 0) MPREV[F.tid * NCH + c] = mprev;
                mprev = bl + Mx; } }
        __syncthreads();
        for (int it = gtid; it < NBH * (DV * DQK / 8); it += GT_) {
            const int bh = it / (DV * DQK / 8), off = (it % (DV * DQK / 8)) * 8;
            float C[8];
#pragma unroll
            for (int j = 0; j < 8; ++j) C[j] = 0.f;
            const bf16_t* p = UT + (size_t)bh * NCH * DV * DQK + off; bf16_t* pc = CT + (size_t)bh * NCH * DV * DQK + off;
            for (int c0 = 0; c0 < NCH; c0 += 8) {
                u32x4 u[8];
#pragma unroll
                for (int q = 0; q < 8; ++q) u[q] = *(const u32x4*)(p + (size_t)(c0 + q) * DV * DQK);
#pragma unroll
                for (int q = 0; q < 8; ++q) { const float s = sc[bh * NCH + c0 + q], g = sc[512 + bh * NCH + c0 + q];
                    u32x4 o; o.x = cvt_pk_bf16(C[0], C[1]); o.y = cvt_pk_bf16(C[2], C[3]); o.z = cvt_pk_bf16(C[4], C[5]); o.w = cvt_pk_bf16(C[6], C[7]);
                    *(u32x4*)(pc + (size_t)(c0 + q) * DV * DQK) = o;
                    C[0] = s * C[0] + g * bf_lo(u[q].x); C[1] = s * C[1] + g * bf_hi(u[q].x); C[2] = s * C[2] + g * bf_lo(u[q].y); C[3] = s * C[3] + g * bf_hi(u[q].y);
                    C[4] = s * C[4] + g * bf_lo(u[q].z); C[5] = s * C[5] + g * bf_hi(u[q].z); C[6] = s * C[6] + g * bf_lo(u[q].w); C[7] = s * C[7] + g * bf_hi(u[q].w); }
            }
        }
        for (int it = gtid; it < NBH * DQK; it += GT_) { const int bh = it / DQK, d = it % DQK; float n = 0.f; const float* p = NU + (size_t)bh * NCH * DQK + d; float* pn = NPV + (size_t)bh * NCH * DQK + d;
            for (int c = 0; c < NCH; ++c) { const float u = p[(size_t)c * DQK]; pn[(size_t)c * DQK] = n; n = sc[bh * NCH + c] * n + sc[512 + bh * NCH + c] * u; } }
        __syncthreads();
        { SchedGVW S{F.G, (int)blockIdx.x, (const char*)KX, (const char*)VX, (const char*)WXQ, (const char*)WXO}; EpiBf16To E{KX, VX, GTb, VWT, 1};
          pg8::gemm_phase<EpiBf16To, SchedGVW, true, true>(F.lds, DM, DM, XDH, S, E); }
    }
    SEAM(3); DIGEST(3);

    if (IN(4)) {
        LAS float* gl = (LAS float*)F.lds;
        LAS float* Ml = gl + 64; LAS float* sil = gl + 128; LAS float* enl = gl + 192; LAS float* qnl = gl + 256; LAS float* rsl = gl + 320; LAS float* ssl = gl + 448;
        LAS bf16_t* Pl = (LAS bf16_t*)(F.lds + 8192);
        const int fr = F.lane & 15, fq = F.lane >> 4;
        for (int un = blockIdx.x; un < NBH * NCH; un += F.G) {
            const int bh = un / NCH, c = un % NCH, b = bh >> 2, h = bh & 3, tok0 = b * SEQ + c * LCH;
            if (F.wave == 0) {
                float li, lf; chunk_gates(G8, args.b_if, tok0, h, F.lane, li, lf);
                const float bc = wave_incl_sum(lf, F.lane); const float g = li - bc; const float mprev = MPREV[un];
                const float Mx = fmaxf(mprev, wave_incl_max(g, F.lane));
                gl[F.lane] = g; Ml[F.lane] = Mx; sil[F.lane] = __expf(mprev - Mx); enl[F.lane] = __expf(-(bc + Mx));
            }
            { const float* np = NPV + (size_t)un * DQK + 4 * F.lane; const f32x4 nv = *(const f32x4*)np;
#pragma unroll
              for (int r = 0; r < 8; ++r) { const int t = F.wave * 8 + r; const u32x2 qv = *(const u32x2*)(Qb + (size_t)(tok0 + t) * QKW + h * DQK + 4 * F.lane);
                  float s = bf_lo(qv.x) * nv[0] + bf_hi(qv.x) * nv[1] + bf_lo(qv.y) * nv[2] + bf_hi(qv.y) * nv[3]; s = wave_sum(s); if (F.lane == 0) qnl[t] = s; } }
            __syncthreads();
            { const int tt = F.wave >> 1, sh = F.wave & 1; f32x4 s0 = (f32x4){0.f, 0.f, 0.f, 0.f}, s1 = s0;
              const bf16_t* qp = Qb + (size_t)(tok0 + tt * 16 + fr) * QKW + h * DQK + 8 * fq;
              const bf16_t* k0 = KN + (size_t)(tok0 + (2 * sh) * 16 + fr) * QKW + h * DQK + 8 * fq; const bf16_t* k1 = k0 + (size_t)16 * QKW;
              if (2 * sh <= tt) {
#pragma unroll
                  for (int ks = 0; ks < 8; ++ks) { const bf16x8 qf = *(const bf16x8*)(qp + 32 * ks); s0 = __builtin_amdgcn_mfma_f32_16x16x32_bf16(*(const bf16x8*)(k0 + 32 * ks), qf, s0, 0, 0, 0);
                      s1 = __builtin_amdgcn_mfma_f32_16x16x32_bf16(*(const bf16x8*)(k1 + 32 * ks), qf, s1, 0, 0, 0); } }
              const int t = tt * 16 + fr; const float Mt = Ml[t]; float rsum = 0.f; u32x2 p0, p1; float pv[8];
#pragma unroll
              for (int r = 0; r < 4; ++r) { const int sa = (2 * sh) * 16 + 4 * fq + r, sb = sa + 16;
                  pv[r] = sa <= t ? s0[r] * __expf(gl[sa] - Mt) : 0.f; pv[4 + r] = sb <= t ? s1[r] * __expf(gl[sb] - Mt) : 0.f; rsum += pv[r] + pv[4 + r]; }
              rsum += __shfl_xor(rsum, 16); rsum += __shfl_xor(rsum, 32);
              if (fq == 0) rsl[t * 2 + sh] = rsum;
              p0.x = cvt_pk_bf16(pv[0], pv[1]); p0.y = cvt_pk_bf16(pv[2], pv[3]); p1.x = cvt_pk_bf16(pv[4], pv[5]); p1.y = cvt_pk_bf16(pv[6], pv[7]);
              *(LAS u32x2*)(Pl + t * 72 + (2 * sh) * 16 + 4 * fq) = p0; *(LAS u32x2*)(Pl + t * 72 + (2 * sh + 1) * 16 + 4 * fq) = p1; }
            __syncthreads();
            f32x4 acc[4][4];
#pragma unroll
            for (int mt = 0; mt < 4; ++mt)
#pragma unroll
                for (int nt = 0; nt < 4; ++nt) acc[mt][nt] = (f32x4){0.f, 0.f, 0.f, 0.f};
            const bf16_t* ct = CT + (size_t)un * DV * DQK + (size_t)(F.wave * 64 + fr) * DQK + 8 * fq;
            const bf16_t* qb = Qb + (size_t)(tok0 + fr) * QKW + h * DQK + 8 * fq;
            if (c > 0) {
#pragma unroll 2
                for (int ks = 0; ks < 8; ++ks) { bf16x8 qf[4], cf[4];
#pragma unroll
                    for (int i = 0; i < 4; ++i) { qf[i] = *(const bf16x8*)(qb + (size_t)i * 16 * QKW + 32 * ks); cf[i] = *(const bf16x8*)(ct + (size_t)i * 16 * DQK + 32 * ks); }
#pragma unroll
                    for (int mt = 0; mt < 4; ++mt)
#pragma unroll
                        for (int nt = 0; nt < 4; ++nt) acc[mt][nt] = __builtin_amdgcn_mfma_f32_16x16x32_bf16(cf[nt], qf[mt], acc[mt][nt], 0, 0, 0); }
            }
#pragma unroll
            for (int mt = 0; mt < 4; ++mt) { const float si = sil[mt * 16 + fr];
#pragma unroll
                for (int nt = 0; nt < 4; ++nt) acc[mt][nt] = acc[mt][nt] * si; }
            const bf16_t* vt = VT + (size_t)(h * DV + F.wave * 64 + fr) * MT + tok0 + 8 * fq;
#pragma unroll
            for (int ks = 0; ks < 2; ++ks) { bf16x8 pf[4], vf[4];
#pragma unroll
                for (int i = 0; i < 4; ++i) { pf[i] = *(const LAS bf16x8*)(Pl + (i * 16 + fr) * 72 + 32 * ks + 8 * fq); vf[i] = *(const bf16x8*)(vt + (size_t)i * 16 * MT + 32 * ks); }
#pragma unroll
                for (int mt = 0; mt < 4; ++mt)
#pragma unroll
                    for (int nt = 0; nt < 4; ++nt) acc[mt][nt] = __builtin_amdgcn_mfma_f32_16x16x32_bf16(vf[nt], pf[mt], acc[mt][nt], 0, 0, 0); }
#pragma unroll
            for (int mt = 0; mt < 4; ++mt) { const int t = mt * 16 + fr; const float den = sil[t] * qnl[t] + rsl[t * 2] + rsl[t * 2 + 1]; const float inv = 1.0f / fmaxf(fabsf(den), enl[t]); float ss = 0.f;
#pragma unroll
                for (int nt = 0; nt < 4; ++nt) { acc[mt][nt] = acc[mt][nt] * inv; ss += (acc[mt][nt][0] * acc[mt][nt][0] + acc[mt][nt][1] * acc[mt][nt][1]) + (acc[mt][nt][2] * acc[mt][nt][2] + acc[mt][nt][3] * acc[mt][nt][3]); }
                ss += __shfl_xor(ss, 16); ss += __shfl_xor(ss, 32);
                if (fq == 0) ssl[t * 8 + F.wave] = ss; }
            __syncthreads();
#pragma unroll
            for (int mt = 0; mt < 4; ++mt) { const int t = mt * 16 + fr; const f32x4 sa = *(const LAS f32x4*)(ssl + t * 8), sb = *(const LAS f32x4*)(ssl + t * 8 + 4);
                const float rstd = rsqrtf(((sa[0] + sa[1]) + (sa[2] + sa[3]) + (sb[0] + sb[1]) + (sb[2] + sb[3])) * (1.0f / DV) + EPS);
#pragma unroll
                for (int nt = 0; nt < 4; ++nt) { const int e = h * DV + F.wave * 64 + nt * 16 + 4 * fq; const size_t o = (size_t)(tok0 + t) * VWD + e;
                    const f32x4 hw = *(const f32x4*)(args.hnorm + e); const u32x2 so = *(const u32x2*)(SO + o);
                    u32x2 ov; ov.x = cvt_pk_bf16(acc[mt][nt][0] * rstd * hw[0] * bf_lo(so.x), acc[mt][nt][1] * rstd * hw[1] * bf_hi(so.x));
                    ov.y = cvt_pk_bf16(acc[mt][nt][2] * rstd * hw[2] * bf_lo(so.y), acc[mt][nt][3] * rstd * hw[3] * bf_hi(so.y));
                    *(u32x2*)(HA + o) = ov; } }
            __syncthreads();
        }
    }
    SEAM(4); DIGEST(4);

    if (IN(5)) {
        SchedPair S; S.T.init(MT / 256, DM / 256, F.G, blockIdx.x); S.HAb = (const char*)HA; S.HBb = (const char*)HBb; S.Wb = (const char*)WBR;
        EpiMerge E{SG, TMP, MRG};
        pg8::gemm_phase<EpiMerge, SchedPair, true, true>(F.lds, VWD, VWD, VWD, S, E);
    }
    SEAM(5); DIGEST(5);
    if (IN(6)) {
        SchedPlain S; S.T.init(MT / 256, DM / 256, F.G, blockIdx.x); S.Ab = (const char*)MRG; S.Bb = (const char*)WMIX; S.lda2 = (size_t)DM * 2; S.ldb2 = (size_t)DM * 2; S.bstride = 0;
        EpiF32To E{Y, DM};
        pg8::gemm_phase<EpiF32To, SchedPlain, true, true>(F.lds, DM, DM, DM, S, E);
    }
    SEAM(6); DIGEST(6);
    if (IN(7)) { for (int m = F.gw; m < MT; m += F.NGW) glue_row(Y + (size_t)m * DM, args.x + (size_t)m * DM, args.n_post_mix, args.out + (size_t)m * DM, args.n_pre_x, Hb + (size_t)m * DM, F.lane); }
    SEAM(7); DIGEST(7);
    if (IN(8)) {
        SchedPlain S; S.T.init(MT / 256, XH, F.G, blockIdx.x); S.Ab = (const char*)Hb; S.Bb = (const char*)GTb; S.lda2 = (size_t)DM * 2; S.ldb2 = (size_t)DM * 2; S.bstride = (size_t)XH * MEML * DM * 2;
        EpiF32To E{SC, XH * MEML};
        pg8::gemm_phase<EpiF32To, SchedPlain, true, true>(F.lds, DM, DM, DM, S, E);
    }
    SEAM(8); DIGEST(8);
    if (IN(9)) {
        for (int m = F.gw; m < MT; m += F.NGW) { const f32x4* sr = (const f32x4*)(SC + (size_t)m * (XH * MEML)) + F.lane; u32x2* pr = (u32x2*)(Pb + (size_t)m * (XH * MEML)) + F.lane;
#pragma unroll
            for (int hh = 0; hh < XH; ++hh) { const f32x4 v = sr[64 * hh] * 0.03125f; const float mx = wave_max(fmaxf(fmaxf(v.x, v.y), fmaxf(v.z, v.w)));
                const float e0 = __expf(v.x - mx), e1 = __expf(v.y - mx), e2 = __expf(v.z - mx), e3 = __expf(v.w - mx); const float inv = 1.0f / wave_sum((e0 + e1) + (e2 + e3));
                u32x2 o; o.x = cvt_pk_bf16(e0 * inv, e1 * inv); o.y = cvt_pk_bf16(e2 * inv, e3 * inv); pr[64 * hh] = o; } }
    }
    SEAM(9); DIGEST(9);
    if (IN(10)) {
        SchedPlain S; S.T.init(MT / 256, DM / 256, F.G, blockIdx.x); S.Ab = (const char*)Pb; S.Bb = (const char*)VWT; S.lda2 = (size_t)XH * MEML * 2; S.ldb2 = (size_t)XH * MEML * 2; S.bstride = (size_t)DM * XH * MEML * 2;
        EpiF32To E{Y, DM};
        pg8::gemm_phase<EpiF32To, SchedPlain, true, true>(F.lds, XH * MEML, XH * MEML, XH * MEML, S, E);
    }
    SEAM(10); DIGEST(10);
    if (IN(11)) { for (int m = F.gw; m < MT; m += F.NGW) glue_row(Y + (size_t)m * DM, args.out + (size_t)m * DM, args.n_post_x, args.out + (size_t)m * DM, args.n_pre_f, Hb + (size_t)m * DM, F.lane); }
    SEAM(11); DIGEST(11);
    if (IN(12)) {
        SchedPlain S; S.T.init(MT / 256, NGU / 256, F.G, blockIdx.x); S.Ab = (const char*)Hb; S.Bb = (const char*)WGU; S.lda2 = (size_t)DM * 2; S.ldb2 = (size_t)DM * 2; S.bstride = 0;
        EpiSwiGLU E{ACT};
        pg8::gemm_phase<EpiSwiGLU, SchedPlain, true, true>(F.lds, DM, DM, DM, S, E);
    }
    SEAM(12); DIGEST(12);
    if (IN(13)) {
        SchedPlain S; S.T.init(MT / 256, DM / 256, F.G, blockIdx.x); S.Ab = (const char*)ACT; S.Bb = (const char*)WD; S.lda2 = (size_t)FF * 2; S.ldb2 = (size_t)FF * 2; S.bstride = 0;
        EpiF32To E{Y, DM};
        pg8::gemm_phase<EpiF32To, SchedPlain, true, true>(F.lds, FF, FF, FF, S, E);
    }
    SEAM(13); DIGEST(13);
    if (IN(14)) { for (int m = F.gw; m < MT; m += F.NGW) glue_row(Y + (size_t)m * DM, args.out + (size_t)m * DM, args.n_post_f, args.out + (size_t)m * DM, nullptr, nullptr, F.lane); }
#undef IN
#undef SEAM
}

extern "C" void kernel_launch(void* const* d_in, const int* in_sizes, int n_in, void* d_out, int out_size, void* d_ws, size_t ws_size, hipStream_t stream) {
    static int grid = 0;
    if (grid == 0) {
        if (n_in != 22 || out_size != MT * DM || ws_size < WS_END) { fprintf(stderr, "kernel_launch: unexpected problem (n_in %d, out %d, ws %zu, need %zu)\n", n_in, out_size, ws_size, (size_t)WS_END); grid = -1; return; }
        int dev = 0, cus = 0, per_cu = 0;
        if (hipGetDevice(&dev) != hipSuccess || hipDeviceGetAttribute(&cus, hipDeviceAttributeMultiprocessorCount, dev) != hipSuccess) { grid = -1; return; }
        if (hipFuncSetAttribute((const void*)fwd_kernel, hipFuncAttributeMaxDynamicSharedMemorySize, LDS_BYTES) != hipSuccess) { fprintf(stderr, "kernel_launch: hipFuncSetAttribute failed\n"); grid = -1; return; }
        if (hipOccupancyMaxActiveBlocksPerMultiprocessor(&per_cu, (const void*)fwd_kernel, NTHR, LDS_BYTES) != hipSuccess || per_cu < 1) { fprintf(stderr, "kernel_launch: occupancy query says %d\n", per_cu); }
        (void)hipGetLastError();
        grid = cus;
    }
    if (grid < 0) return;
    (void)hipMemsetAsync((char*)d_ws + WS_CTL, 0, CTL_BYTES, stream);
    Args a{};
    const float** f = (const float**)&a;
    for (int i = 0; i < 22; ++i) f[i] = (const float*)d_in[i];
    a.out = (float*)d_out; a.ws = (unsigned char*)d_ws;
#if MK_PER_PHASE
    for (int p = 0; p < (DBG_STOP >= 0 ? DBG_STOP + 2 : NPH); ++p) { a.ph_lo = p; a.ph_hi = p + 1; hipLaunchKernelGGL(fwd_kernel, dim3(grid), dim3(NTHR), LDS_BYTES, stream, a); }
#else
    a.ph_lo = 0; a.ph_hi = NPH; hipLaunchKernelGGL(fwd_kernel, dim3(grid), dim3(NTHR), LDS_BYTES, stream, a);
#endif
}
```
